# Optimizing an MI355X kernel written in HIP

```python
import jax, jax.numpy as jnp
from jax import lax
import numpy as np

D_MODEL = 1024
BATCH = 8
SEQ = 2048
DEPTH = 2
DEC_BATCH = 128
DEC_SEQ = 8
PAST_LEN = 16384
PAGE_SIZE = 128

CHUNK = 128
NH_A = 4
HD_A = 128
D_A = NH_A * HD_A
NH_B = 8
HD_B = 64
D_B = NH_B * HD_B
CONV_W = 3
D_IN_EVEN = 2 * D_A + 3 * D_B
POOL_WINDOWS = (2, 4, 8, 16)
N_POOL_GROUPS = len(POOL_WINDOWS)
POOL_GC = D_MODEL // N_POOL_GROUPS
POOL_CTX = max(POOL_WINDOWS) - 1
D_FF = 128 * ((8 * D_MODEL // 3 + 127) // 128)
N_EVEN = (DEPTH + 1) // 2
N_ODD = DEPTH // 2
EPS = 1e-6

kernel_name = 'hybrid_sgu_shortconv_pool_macaron_step'


def _rmsnorm(x, g):
    xf = x.astype(jnp.float32)
    y = xf * lax.rsqrt(jnp.mean(xf * xf, axis=-1, keepdims=True) + EPS) * g.astype(jnp.float32)
    return y.astype(x.dtype)


def _layernorm(x, g, b):
    xf = x.astype(jnp.float32)
    mu = jnp.mean(xf, axis=-1, keepdims=True)
    var = jnp.mean(jnp.square(xf - mu), axis=-1, keepdims=True)
    y = (xf - mu) * lax.rsqrt(var + EPS) * g.astype(jnp.float32) + b.astype(jnp.float32)
    return y.astype(x.dtype)


def _swiglu(h, w_gate, w_up, w_down):
    return (jax.nn.silu(h @ w_gate) * (h @ w_up)) @ w_down


def _sgu(u, v, w_s, b_s, chunk_len):
    b, L, _ = v.shape
    n_c = L // chunk_len
    mask = jnp.tril(jnp.ones((chunk_len, chunk_len), dtype=bool))
    w = jnp.where(mask[None], w_s[:, :chunk_len, :chunk_len], 0.0).astype(v.dtype)
    vc = v.reshape(b, n_c, chunk_len, NH_A, HD_A)
    mixed = jnp.einsum('hts,bcshd->bcthd', w, vc) + b_s[:, :chunk_len].T[None, None, :, :, None]
    return u * mixed.reshape(b, L, D_A)


def _even_mixer(h, conv_buf, chunk_len, w_in, ln_g, ln_b, sgu_w, sgu_b, conv_w, w_out):
    L = h.shape[1]
    z = h @ w_in
    uv = jax.nn.gelu(z[..., :2 * D_A], approximate=False)
    u = uv[..., :D_A]
    v = _layernorm(uv[..., D_A:], ln_g, ln_b)
    y_a = _sgu(u, v, sgu_w, sgu_b, chunk_len)
    o = 2 * D_A
    gate_b = z[..., o:o + D_B]
    gate_c = z[..., o + D_B:o + 2 * D_B]
    x_in = z[..., o + 2 * D_B:o + 3 * D_B]
    xg = gate_c * x_in
    ext = jnp.concatenate([conv_buf.astype(xg.dtype), xg], axis=1)
    conv = ext[:, 0:L] * conv_w[0]
    for k in range(1, CONV_W):
        conv = conv + ext[:, k:k + L] * conv_w[k]
    y_b = gate_b * conv
    out = jnp.concatenate([y_a, y_b], axis=-1) @ w_out
    return out, ext[:, -(CONV_W - 1):], v


def _odd_mixer(h, pool_buf, pos, w_in, pool_w, pool_scale, w_out):
    b, T, _ = h.shape
    p = h @ w_in
    ext = jnp.concatenate([pool_buf.astype(p.dtype), p], axis=1)
    c = jnp.cumsum(ext.astype(jnp.float32), axis=1)
    c = jnp.concatenate([jnp.zeros_like(c[:, :1]), c], axis=1)
    end = c[:, POOL_CTX + 1:]
    pf = p.astype(jnp.float32)
    outs = []
    for g, w in enumerate(POOL_WINDOWS):
        sl = slice(g * POOL_GC, (g + 1) * POOL_GC)
        start = c[:, POOL_CTX + 1 - w:POOL_CTX + 1 - w + T, sl]
        cnt = jnp.minimum(pos + 1, w).astype(jnp.float32)[None, :, None]
        outs.append((end[..., sl] - start) / cnt - pf[..., sl])
    d = jnp.stack(outs, axis=2).astype(p.dtype)
    y = jnp.einsum('btgc,gcd->btgd', d, pool_w).reshape(b, T, D_MODEL) * pool_scale
    return y @ w_out, ext[:, -POOL_CTX:]


def _trunk(x, conv_bufs, pool_bufs, pos, chunk_len, keep_v,
           norm_g, final_norm_g, ffn_w_gate, ffn_w_up, ffn_w_down,
           e_w_in, e_ln_g, e_ln_b, e_sgu_w, e_sgu_b, e_conv_w, e_w_out,
           o_w_in, o_pool_w, o_pool_scale, o_w_out):
    new_conv, new_pool, v_rows = [], [], []
    for layer in range(DEPTH):
        i = layer // 2
        x = x + 0.5 * _swiglu(_rmsnorm(x, norm_g[layer, 0]),
                              ffn_w_gate[layer, 0], ffn_w_up[layer, 0], ffn_w_down[layer, 0])
        h = _rmsnorm(x, norm_g[layer, 1])
        if layer % 2 == 0:
            m, cb, v = _even_mixer(h, conv_bufs[i], chunk_len, e_w_in[i], e_ln_g[i], e_ln_b[i],
                                   e_sgu_w[i], e_sgu_b[i], e_conv_w[i], e_w_out[i])
            new_conv.append(cb)
            v_rows.append(v)
        else:
            m, pb = _odd_mixer(h, pool_bufs[i], pos, o_w_in[i], o_pool_w[i], o_pool_scale[i], o_w_out[i])
            new_pool.append(pb)
        x = x + m
        x = x + 0.5 * _swiglu(_rmsnorm(x, norm_g[layer, 2]),
                              ffn_w_gate[layer, 1], ffn_w_up[layer, 1], ffn_w_down[layer, 1])
    y = _rmsnorm(x, final_norm_g)
    v_out = jnp.stack(v_rows) if keep_v else None
    return y, jnp.stack(new_conv), v_out, jnp.stack(new_pool)


def setup_inputs(seed: int = 0) -> dict:
    key = jax.random.key(seed)
    ks = jax.random.split(key, 24)
    f32 = jnp.float32
    nrm = lambda k, shape, s: (jax.random.normal(k, shape, f32) * s).astype(f32)
    return {
        'x_prompt': nrm(ks[0], (BATCH, SEQ, D_MODEL), 1.0),
        'x_sample': nrm(ks[1], (DEC_BATCH, DEC_SEQ, D_MODEL), 1.0),
        'state_conv': nrm(ks[2], (N_EVEN, DEC_BATCH, CONV_W - 1, D_B), 0.5),
        'state_pool': nrm(ks[3], (N_ODD, DEC_BATCH, POOL_CTX, D_MODEL), 0.5),
        'norm_g': 1.0 + nrm(ks[4], (DEPTH, 3, D_MODEL), 0.02),
        'final_norm_g': 1.0 + nrm(ks[5], (D_MODEL,), 0.02),
        'ffn_w_gate': nrm(ks[6], (DEPTH, 2, D_MODEL, D_FF), D_MODEL ** -0.5),
        'ffn_w_up': nrm(ks[7], (DEPTH, 2, D_MODEL, D_FF), D_MODEL ** -0.5),
        'ffn_w_down': nrm(ks[8], (DEPTH, 2, D_FF, D_MODEL), D_FF ** -0.5),
        'e_w_in': nrm(ks[9], (N_EVEN, D_MODEL, D_IN_EVEN), D_MODEL ** -0.5),
        'e_ln_g': 1.0 + nrm(ks[10], (N_EVEN, D_A), 0.02),
        'e_ln_b': nrm(ks[11], (N_EVEN, D_A), 0.02),
        'e_sgu_w': nrm(ks[12], (N_EVEN, NH_A, CHUNK, CHUNK), CHUNK ** -0.5),
        'e_sgu_b': 1.0 + nrm(ks[13], (N_EVEN, NH_A, CHUNK), 0.02),
        'e_conv_w': nrm(ks[14], (N_EVEN, CONV_W, D_B), CONV_W ** -0.5),
        'e_w_out': nrm(ks[15], (N_EVEN, D_A + D_B, D_MODEL), (D_A + D_B) ** -0.5),
        'o_w_in': nrm(ks[16], (N_ODD, D_MODEL, D_MODEL), D_MODEL ** -0.5),
        'o_pool_w': nrm(ks[17], (N_ODD, N_POOL_GROUPS, POOL_GC, POOL_GC), POOL_GC ** -0.5),
        'o_pool_scale': 1.0 + nrm(ks[18], (N_ODD, D_MODEL), 0.02),
        'o_w_out': nrm(ks[19], (N_ODD, D_MODEL, D_MODEL), D_MODEL ** -0.5),
    }


def reference(x_prompt, x_sample, state_conv, state_pool, norm_g, final_norm_g,
              ffn_w_gate, ffn_w_up, ffn_w_down, e_w_in, e_ln_g, e_ln_b, e_sgu_w, e_sgu_b,
              e_conv_w, e_w_out, o_w_in, o_pool_w, o_pool_scale, o_w_out):
    weights = (norm_g, final_norm_g, ffn_w_gate, ffn_w_up, ffn_w_down,
               e_w_in, e_ln_g, e_ln_b, e_sgu_w, e_sgu_b, e_conv_w, e_w_out,
               o_w_in, o_pool_w, o_pool_scale, o_w_out)
    pos_p = jnp.arange(SEQ, dtype=jnp.int32)
    conv0 = jnp.zeros((N_EVEN, BATCH, CONV_W - 1, D_B), x_prompt.dtype)
    pool0 = jnp.zeros((N_ODD, BATCH, POOL_CTX, D_MODEL), x_prompt.dtype)
    y_prompt, conv_prompt, _, pool_prompt = _trunk(
        x_prompt, conv0, pool0, pos_p, CHUNK, False, *weights)
    pos_s = PAST_LEN + jnp.arange(DEC_SEQ, dtype=jnp.int32)
    y_sample, conv_sample, chunk_v_sample, pool_sample = _trunk(
        x_sample, state_conv, state_pool, pos_s, DEC_SEQ, True, *weights)
    return (y_prompt, y_sample, conv_prompt, conv_sample, chunk_v_sample, pool_prompt, pool_sample)
```

```cpp
#include <hip/hip_runtime.h>
#include <cstdio>
#include <cstdint>

#ifndef MK_N_LAUNCHES
#define MK_N_LAUNCHES 1
#endif

#define GAS __attribute__((address_space(1)))
#define LAS __attribute__((address_space(3)))
typedef unsigned short bf16;
typedef short bf16x8 __attribute__((ext_vector_type(8)));
typedef float f32x4 __attribute__((ext_vector_type(4)));
typedef float f32x2 __attribute__((ext_vector_type(2)));
typedef unsigned u32x4 __attribute__((ext_vector_type(4)));
typedef unsigned u32x2 __attribute__((ext_vector_type(2)));
typedef GAS unsigned gu32;

constexpr int DM = 1024, FF = 2816, NGU = 2 * FF, NWIN = 2560, DA = 512;
constexpr int MP = 16384, MS = 1024, M = MP + MS;
constexpr int SEQ = 2048, DSEQ = 8, POOLCTX = 15;
constexpr float EPS = 1e-6f;
constexpr int NPHASE = 16;

constexpr size_t MiB = 1u << 20;
constexpr size_t WS_CTL = 0, CTL_ZERO_BYTES = 1 * MiB;
constexpr size_t WS_SS = 64 * 1024;
constexpr size_t WS_WGU = 1 * MiB;
constexpr size_t WS_WD = 45 * MiB;
constexpr size_t WD_BYTES = (size_t)DM * FF * 2;
constexpr size_t WS_WIN = 67 * MiB;
constexpr size_t WS_WOUT = 72 * MiB, WS_OWIN = 74 * MiB, WS_WCOMB = 76 * MiB;
constexpr size_t WS_XB = 78 * MiB;
constexpr size_t WS_HID = 112 * MiB;
constexpr size_t WS_U = 112 * MiB, WS_V = 129 * MiB, WS_GB = 146 * MiB, WS_XG = 163 * MiB;
constexpr size_t WS_P = 112 * MiB, WS_D = 146 * MiB;
constexpr size_t WS_Y = 206 * MiB;
constexpr size_t WS_END = 240 * MiB;
static_assert(WS_WD + 4 * WD_BYTES <= WS_WIN && WS_HID + (size_t)M * FF * 2 <= WS_Y && WS_SS + 9 * (size_t)M * 4 <= CTL_ZERO_BYTES, "ws map");
constexpr int CW_TMO = 0, CW_CODE = 1, CW_BAR = 4096;

constexpr size_t O_Y = 0;
constexpr size_t O_CONVP = (size_t)M * DM;
constexpr size_t O_CONVS = O_CONVP + 8 * 2 * 512;
constexpr size_t O_CHV = O_CONVS + 128 * 2 * 512;
constexpr size_t O_POOLP = O_CHV + (size_t)128 * 8 * 512;
constexpr size_t O_POOLS = O_POOLP + (size_t)8 * 15 * 1024;

constexpr int RING_BYTES = 131072, LDSCTL_OFF = RING_BYTES, MISC_OFF = LDSCTL_OFF + 320, LDS_BYTES = 147456;

__device__ __forceinline__ unsigned cvt_pk_bf16(float lo, float hi) { unsigned r; asm("v_cvt_pk_bf16_f32 %0, %1, %2" : "=v"(r) : "v"(lo), "v"(hi)); return r; }
__device__ __forceinline__ float bf_lo(unsigned w) { return __uint_as_float(w << 16); }
__device__ __forceinline__ float bf_hi(unsigned w) { return __uint_as_float(w & 0xffff0000u); }
__device__ __forceinline__ u32x4 pack8(f32x4 a, f32x4 b) { u32x4 w; w.x = cvt_pk_bf16(a[0], a[1]); w.y = cvt_pk_bf16(a[2], a[3]); w.z = cvt_pk_bf16(b[0], b[1]); w.w = cvt_pk_bf16(b[2], b[3]); return w; }
__device__ __forceinline__ void unpack8(u32x4 w, f32x4& a, f32x4& b) { a = (f32x4){bf_lo(w.x), bf_hi(w.x), bf_lo(w.y), bf_hi(w.y)}; b = (f32x4){bf_lo(w.z), bf_hi(w.z), bf_lo(w.w), bf_hi(w.w)}; }
__device__ __forceinline__ float silu_f(float x) { return x * __builtin_amdgcn_rcpf(1.0f + __builtin_amdgcn_exp2f(-1.4426950408889634f * x)); }
__device__ __forceinline__ f32x4 silu4(f32x4 g) { return (f32x4){silu_f(g[0]), silu_f(g[1]), silu_f(g[2]), silu_f(g[3])}; }
__device__ __forceinline__ f32x2 gelu_pk(f32x2 v) {
    const f32x2 av = __builtin_elementwise_abs(v), d = av * 0.2316418882f + 1.0f;
    f32x2 t; t.x = __builtin_amdgcn_rcpf(d.x); t.y = __builtin_amdgcn_rcpf(d.y);
    f32x2 q = t * 0.5307027145f + (-0.7265760135f); q = q * t + 0.7107068705f; q = q * t + (-0.142248368f); q = q * t + 0.127414796f; q = q * t;
    const f32x2 s = (v * v) * (-0.72134752044f);
    f32x2 e; e.x = __builtin_amdgcn_exp2f(s.x); e.y = __builtin_amdgcn_exp2f(s.y);
    const f32x2 m = v * (q * e), r = v - m;
    f32x2 o; o.x = v.x < 0.f ? m.x : r.x; o.y = v.y < 0.f ? m.y : r.y; return o;
}
__device__ __forceinline__ f32x4 gelu4(f32x4 v) { const f32x2 a = gelu_pk((f32x2){v[0], v[1]}), b = gelu_pk((f32x2){v[2], v[3]}); return (f32x4){a.x, a.y, b.x, b.y}; }
__device__ __forceinline__ float hsum4(f32x4 v) { return (v[0] + v[1]) + (v[2] + v[3]); }
__device__ __forceinline__ float hsq4(f32x4 v) { return (v[0] * v[0] + v[1] * v[1]) + (v[2] * v[2] + v[3] * v[3]); }

namespace pg8 {
constexpr int BM = 256, BK = 64, HALF = 128, HTB = HALF * BK * 2, STAGE_BYTES = 8 * HTB, NXCD = 8, WGM = 8;
__host__ __device__ __forceinline__ int lds_byte(int r, int c) { const int st = (r >> 4) * 2 + (c >> 5), rr = r & 15, cc = c & 31, ob = rr * 64 + cc * 2; return st * 1024 + (ob ^ (((ob >> 9) & 1) << 5)); }
__host__ __device__ __forceinline__ void stage_rc(int b, int& R, int& C) { const int st = b / 1024, sb = b % 1024, swz = sb ^ (((sb >> 9) & 1) << 5); R = (st >> 1) * 16 + swz / 64; C = (st & 1) * 32 + (swz % 64) / 2; }
__host__ __device__ __forceinline__ int perm32(int rho) { const int n = rho >> 4, i = rho & 15; return 8 * (i >> 2) + 4 * n + (i & 3); }
struct Unit { int pm, pn; };
struct Gemm { const bf16* A; const bf16* Bt; int M, N, K; };
struct StaticOrder {
    int nM, nN, nwg, G, c;
    __device__ void init(int M_, int N_, int G_, int c_) { nM = M_ / BM; nN = N_ / BM; nwg = nM * nN; G = G_; c = c_; }
    __device__ bool next(int i, Unit& u) const {
        const long L = (long)i * G + c; if (L >= nwg) return false;
        int wgid = (int)L; { const int q = nwg / NXCD, r = nwg % NXCD, xcd = wgid % NXCD, off = wgid / NXCD; wgid = (xcd < r ? xcd * (q + 1) : r * (q + 1) + (xcd - r) * q) + off; }
        const int nig = WGM * nN, gid = wgid / nig, fm = gid * WGM, gsz = (nM - fm) < WGM ? (nM - fm) : WGM;
        u.pm = fm + ((wgid % nig) % gsz); u.pn = (wgid % nig) / gsz; return true;
    }
};
}

struct EpiP {
    int mode;
    float scale;
    int si, so;
    int first;
    unsigned char* ws; float* out; const float* xp; const float* xs;
};

__device__ __forceinline__ void run_epi(const EpiP& E, const f32x4 (&acc)[2][2][4][2], const pg8::Unit& u, int wr, int wc, int fr, int fq) {
    const int r0 = u.pm * 256 + wr * 64 + fr;
    if (E.mode == 1) {
        const float* res = E.first ? ((u.pm < MP / 256) ? E.xp : E.xs - (size_t)MP * DM) : E.out;
        float* xout = E.out; bf16* xb = (bf16*)(E.ws + WS_XB); float* ss_out = (float*)(E.ws + WS_SS) + (size_t)E.so * M;
        const int c0 = u.pn * 256 + wc * 32 + 8 * fq;
#pragma unroll
        for (int ai = 0; ai < 2; ++ai)
#pragma unroll
            for (int m = 0; m < 4; ++m) {
                const int r = r0 + ai * 128 + m * 16; float sq = 0.f;
#pragma unroll
                for (int bj = 0; bj < 2; ++bj) {
                    const size_t off = (size_t)r * DM + c0 + bj * 128;
                    f32x4 x0 = *(const f32x4*)(res + off), x1 = *(const f32x4*)(res + off + 4);
                    x0 = x0 + E.scale * acc[ai][bj][m][0]; x1 = x1 + E.scale * acc[ai][bj][m][1];
                    *(f32x4*)(xout + off) = x0; *(f32x4*)(xout + off + 4) = x1;
                    *(u32x4*)(xb + off) = pack8(x0, x1);
                    sq += hsq4(x0) + hsq4(x1);
                }
                sq += __shfl_xor(sq, 16); sq += __shfl_xor(sq, 32);
                if (fq == 0) atomicAdd(ss_out + r, sq);
            }
        return;
    }
    const float* ss_in = (const float*)(E.ws + WS_SS) + (size_t)E.si * M;
    if (E.mode == 0) {
        bf16* hid = (bf16*)(E.ws + WS_HID);
        const int c0 = u.pn * 128 + wc * 32 + 8 * fq;
#pragma unroll
        for (int ai = 0; ai < 2; ++ai)
#pragma unroll
            for (int m = 0; m < 4; ++m) {
                const int r = r0 + ai * 128 + m * 16;
                const float rs = __builtin_amdgcn_rsqf(ss_in[r] * (1.0f / DM) + EPS);
                const f32x4 h0 = silu4(acc[ai][0][m][0] * rs) * (acc[ai][1][m][0] * rs), h1 = silu4(acc[ai][0][m][1] * rs) * (acc[ai][1][m][1] * rs);
                *(u32x4*)(hid + (size_t)r * FF + c0) = pack8(h0, h1);
            }
        return;
    }
    if (E.mode == 3) {
        bf16* Pb = (bf16*)(E.ws + WS_P); float* pool_p = E.out + O_POOLP; float* pool_s = E.out + O_POOLS;
        const int c0 = u.pn * 256 + wc * 32 + 8 * fq;
#pragma unroll
        for (int ai = 0; ai < 2; ++ai)
#pragma unroll
            for (int m = 0; m < 4; ++m) {
                const int r = r0 + ai * 128 + m * 16;
                const float rs = __builtin_amdgcn_rsqf(ss_in[r] * (1.0f / DM) + EPS);
                float* po = nullptr;
                if (r < MP) { const int t = r & (SEQ - 1); if (t >= SEQ - POOLCTX) po = pool_p + ((size_t)(r >> 11) * POOLCTX + (t - (SEQ - POOLCTX))) * DM; }
                else { const int rr = r - MP; po = pool_s + ((size_t)(rr >> 3) * POOLCTX + (POOLCTX - DSEQ) + (rr & 7)) * DM; }
#pragma unroll
                for (int bj = 0; bj < 2; ++bj) {
                    const f32x4 p0 = acc[ai][bj][m][0] * rs, p1 = acc[ai][bj][m][1] * rs;
                    *(u32x4*)(Pb + (size_t)r * DM + c0 + bj * 128) = pack8(p0, p1);
                    if (po) { *(f32x4*)(po + c0 + bj * 128) = p0; *(f32x4*)(po + c0 + bj * 128 + 4) = p1; }
                }
            }
        return;
    }
    if (u.pn < 6) {
        const int which = u.pn >> 1;
        bf16* dst = (bf16*)(E.ws + (which == 0 ? WS_U : (which == 1 ? WS_V : WS_GB)));
        float* vsum = (float*)(E.ws + WS_SS) + (size_t)7 * M; float* vsq = vsum + M;
        const int c0 = (u.pn & 1) * 256 + wc * 32 + 8 * fq;
#pragma unroll
        for (int ai = 0; ai < 2; ++ai)
#pragma unroll
            for (int m = 0; m < 4; ++m) {
                const int r = r0 + ai * 128 + m * 16;
                const float rs = __builtin_amdgcn_rsqf(ss_in[r] * (1.0f / DM) + EPS);
                float s = 0.f, q = 0.f;
#pragma unroll
                for (int bj = 0; bj < 2; ++bj) {
                    f32x4 z0 = acc[ai][bj][m][0] * rs, z1 = acc[ai][bj][m][1] * rs;
                    if (which < 2) { z0 = gelu4(z0); z1 = gelu4(z1); }
                    if (which == 1) { s += hsum4(z0) + hsum4(z1); q += hsq4(z0) + hsq4(z1); }
                    *(u32x4*)(dst + (size_t)r * DA + c0 + bj * 128) = pack8(z0, z1);
                }
                if (which == 1) {
                    s += __shfl_xor(s, 16); s += __shfl_xor(s, 32); q += __shfl_xor(q, 16); q += __shfl_xor(q, 32);
                    if (fq == 0) { atomicAdd(vsum + r, s); atomicAdd(vsq + r, q); }
                }
            }
    } else {
        bf16* XGb = (bf16*)(E.ws + WS_XG); float* conv_p = E.out + O_CONVP; float* conv_s = E.out + O_CONVS;
        const int c0 = (u.pn - 6) * 128 + wc * 32 + 8 * fq;
#pragma unroll
        for (int ai = 0; ai < 2; ++ai)
#pragma unroll
            for (int m = 0; m < 4; ++m) {
                const int r = r0 + ai * 128 + m * 16;
                const float rs = __builtin_amdgcn_rsqf(ss_in[r] * (1.0f / DM) + EPS);
                const float rs2 = rs * rs;
                const f32x4 x0 = (acc[ai][0][m][0] * acc[ai][1][m][0]) * rs2, x1 = (acc[ai][0][m][1] * acc[ai][1][m][1]) * rs2;
                *(u32x4*)(XGb + (size_t)r * DA + c0) = pack8(x0, x1);
                float* co = nullptr;
                if (r < MP) { const int t = r & (SEQ - 1); if (t >= SEQ - 2) co = conv_p + ((size_t)(r >> 11) * 2 + (t - (SEQ - 2))) * 512; }
                else { const int rr = r - MP, t = rr & 7; if (t >= DSEQ - 2) co = conv_s + ((size_t)(rr >> 3) * 2 + (t - (DSEQ - 2))) * 512; }
                if (co) { *(f32x4*)(co + c0) = x0; *(f32x4*)(co + c0 + 4) = x1; }
            }
    }
}

template <bool ALIGN_EPI, bool SP2>
__device__ __forceinline__ void gemm_phase(LAS unsigned char* lds, const pg8::Gemm g, const pg8::StaticOrder& S, const EpiP& E, const int tid) {
    using namespace pg8;
    const int wid = __builtin_amdgcn_readfirstlane(tid >> 6), lane = tid & 63, wr = wid >> 2, wc = wid & 3, fr = lane & 15, fq = lane >> 4;
    const int K = g.K, nt = K / BK;
    unsigned voffA[2], voffB[2];
#pragma unroll
    for (int i = 0; i < 2; ++i) { int R, C; stage_rc(tid * 16 + i * 8192, R, C); const int Rb = (R & ~31) + perm32(R & 31);
        voffA[i] = (unsigned)(R * K + C) * 2u; voffB[i] = (unsigned)(Rb * K + C) * 2u; }
    const size_t kstep = (size_t)(BK * 2);
    const size_t hstep = (size_t)HALF * K * 2;
    const size_t tstep = 2 * hstep;
    const unsigned ldsw = (unsigned)wid * 1024u;
    const int aoff = lds_byte(wr * 64 + fr, fq * 8), boff = lds_byte(wc * 32 + fr, fq * 8);
#define PG8_SA(b, h) (((b) * 2 + (h)) * HTB)
#define PG8_SB(b, h) ((4 + (b) * 2 + (h)) * HTB)
#define PG8_STAGE(bufoff, gbase, voff) do { _Pragma("unroll") for (int _i = 0; _i < 2; ++_i) \
        __builtin_amdgcn_global_load_lds((const unsigned*)((const char*)(gbase) + (voff)[_i]), (LAS unsigned*)(lds + (bufoff) + ldsw + _i * 8192), 16, 0, 0); } while (0)
#define PG8_LDA(dst, b, h) do { _Pragma("unroll") for (int m = 0; m < 4; ++m) _Pragma("unroll") for (int k = 0; k < 2; ++k) dst[m][k] = *(const LAS bf16x8*)(lds + PG8_SA(b, h) + aoff + m * 2048 + k * 1024); } while (0)
#define PG8_LDB(dst, b, h) do { _Pragma("unroll") for (int n = 0; n < 2; ++n) _Pragma("unroll") for (int k = 0; k < 2; ++k) dst[n][k] = *(const LAS bf16x8*)(lds + PG8_SB(b, h) + boff + n * 2048 + k * 1024); } while (0)
#define PG8_MMA(ai, bj, At, Bt) do { __builtin_amdgcn_s_setprio(1); _Pragma("unroll") for (int m = 0; m < 4; ++m) _Pragma("unroll") for (int n = 0; n < 2; ++n) _Pragma("unroll") for (int k = 0; k < 2; ++k) \
        acc[ai][bj][m][n] = __builtin_amdgcn_mfma_f32_16x16x32_bf16(Bt[n][k], At[m][k], acc[ai][bj][m][n], 0, 0, 0); __builtin_amdgcn_s_setprio(0); } while (0)
#define PG8_WAIT_V(n) asm volatile("s_waitcnt vmcnt(" #n ")" ::: "memory")
#define PG8_WAIT_L(n) asm volatile("s_waitcnt lgkmcnt(" #n ")" ::: "memory")
#define PG8_BAR __builtin_amdgcn_s_barrier()
#define PG8_SCHED __builtin_amdgcn_sched_barrier(0)
    Unit cur, nxt; int ui = 0;
    if (!S.next(0, cur)) return;
    f32x4 acc[2][2][4][2];
#pragma unroll
    for (int a = 0; a < 2; ++a)
#pragma unroll
        for (int b = 0; b < 2; ++b)
#pragma unroll
            for (int m = 0; m < 4; ++m)
#pragma unroll
                for (int n = 0; n < 2; ++n) acc[a][b][m][n] = (f32x4){0.f, 0.f, 0.f, 0.f};
    bf16x8 At[4][2], B0[2][2], B1[2][2];
    const char* cA = (const char*)g.A + (size_t)cur.pm * tstep; const char* cB = (const char*)g.Bt + (size_t)cur.pn * tstep;
    if constexpr (SP2) {
        PG8_STAGE(PG8_SB(0, 0), cB, voffB); PG8_STAGE(PG8_SB(0, 1), cB + hstep, voffB); PG8_STAGE(PG8_SA(0, 0), cA, voffA); PG8_STAGE(PG8_SA(0, 1), cA + hstep, voffA);
        if (wr == 1) PG8_BAR;
        PG8_WAIT_V(2); PG8_BAR;
        PG8_STAGE(PG8_SB(1, 0), cB + kstep, voffB); PG8_STAGE(PG8_SA(1, 0), cA + kstep, voffA); PG8_STAGE(PG8_SB(1, 1), cB + hstep + kstep, voffB);
        PG8_WAIT_V(6); PG8_BAR;
    } else {
        PG8_STAGE(PG8_SB(0, 0), cB, voffB); PG8_STAGE(PG8_SA(0, 0), cA, voffA); PG8_STAGE(PG8_SB(0, 1), cB + hstep, voffB); PG8_STAGE(PG8_SA(0, 1), cA + hstep, voffA);
        if (wr == 1) PG8_BAR;
        PG8_WAIT_V(4); PG8_BAR;
        PG8_STAGE(PG8_SB(1, 0), cB + kstep, voffB); PG8_STAGE(PG8_SA(1, 0), cA + kstep, voffA); PG8_STAGE(PG8_SB(1, 1), cB + hstep + kstep, voffB);
        PG8_WAIT_V(6); PG8_BAR;
    }
    for (;;) {
        const bool has_next = S.next(ui + 1, nxt);
        const char* nA = has_next ? (const char*)g.A + (size_t)nxt.pm * tstep : cA; const char* nB = has_next ? (const char*)g.Bt + (size_t)nxt.pn * tstep : cB;
        for (int t = 0; t < nt; t += 2) {
            const bool last = (t == nt - 2);
            const char* a1 = cA + (size_t)(t + 1) * kstep;
            const char* a2 = last ? nA : cA + (size_t)(t + 2) * kstep; const char* b2 = last ? nB : cB + (size_t)(t + 2) * kstep;
            const char* a3 = a2 + kstep; const char* b3 = b2 + kstep;
            if constexpr (SP2) {
            PG8_LDB(B0, 0, 0); PG8_LDB(B1, 0, 1); PG8_SCHED; PG8_LDA(At, 0, 0); PG8_STAGE(PG8_SA(1, 1), a1 + hstep, voffA);
            PG8_WAIT_V(8); PG8_WAIT_L(0); PG8_BAR; PG8_MMA(0, 0, At, B0); PG8_MMA(0, 1, At, B1); PG8_BAR; PG8_SCHED;
            PG8_LDA(At, 0, 1); PG8_STAGE(PG8_SB(0, 0), b2, voffB); PG8_STAGE(PG8_SB(0, 1), b2 + hstep, voffB); PG8_STAGE(PG8_SA(0, 0), a2, voffA);
            PG8_WAIT_V(8); PG8_WAIT_L(0); PG8_BAR; PG8_MMA(1, 0, At, B0); PG8_MMA(1, 1, At, B1); PG8_BAR; PG8_SCHED;
            PG8_LDB(B0, 1, 0); PG8_LDB(B1, 1, 1); PG8_SCHED; PG8_LDA(At, 1, 0); PG8_STAGE(PG8_SA(0, 1), a2 + hstep, voffA);
            PG8_WAIT_V(8); PG8_WAIT_L(0); PG8_BAR; PG8_MMA(0, 0, At, B0); PG8_MMA(0, 1, At, B1); PG8_BAR; PG8_SCHED;
            PG8_LDA(At, 1, 1); PG8_STAGE(PG8_SB(1, 0), b3, voffB); PG8_STAGE(PG8_SB(1, 1), b3 + hstep, voffB); PG8_STAGE(PG8_SA(1, 0), a3, voffA);
            PG8_WAIT_V(8); PG8_WAIT_L(0); PG8_BAR; PG8_MMA(1, 0, At, B0); PG8_MMA(1, 1, At, B1); PG8_BAR; PG8_SCHED;
            } else {
            PG8_LDB(B0, 0, 0); PG8_SCHED; PG8_LDA(At, 0, 0); PG8_STAGE(PG8_SA(1, 1), a1 + hstep, voffA);
            PG8_WAIT_L(8); PG8_BAR; PG8_WAIT_L(0); PG8_MMA(0, 0, At, B0); PG8_BAR; PG8_SCHED;
            PG8_LDB(B1, 0, 1); PG8_STAGE(PG8_SB(0, 0), b2, voffB);
            PG8_BAR; PG8_WAIT_L(0); PG8_MMA(0, 1, At, B1); PG8_BAR;
            PG8_LDA(At, 0, 1); PG8_STAGE(PG8_SA(0, 0), a2, voffA);
            PG8_BAR; PG8_WAIT_L(0); PG8_MMA(1, 0, At, B0); PG8_BAR; PG8_SCHED;
            PG8_STAGE(PG8_SB(0, 1), b2 + hstep, voffB);
            PG8_WAIT_V(6); PG8_BAR; PG8_MMA(1, 1, At, B1); PG8_BAR;
            PG8_LDB(B0, 1, 0); PG8_SCHED; PG8_LDA(At, 1, 0); PG8_STAGE(PG8_SA(0, 1), a2 + hstep, voffA);
            PG8_WAIT_L(8); PG8_BAR; PG8_WAIT_L(0); PG8_MMA(0, 0, At, B0); PG8_BAR; PG8_SCHED;
            PG8_LDB(B1, 1, 1); PG8_STAGE(PG8_SB(1, 0), b3, voffB);
            PG8_BAR; PG8_WAIT_L(0); PG8_MMA(0, 1, At, B1); PG8_BAR;
            PG8_LDA(At, 1, 1); PG8_STAGE(PG8_SA(1, 0), a3, voffA);
            PG8_BAR; PG8_WAIT_L(0); PG8_MMA(1, 0, At, B0); PG8_BAR; PG8_SCHED;
            PG8_STAGE(PG8_SB(1, 1), b3 + hstep, voffB);
            PG8_WAIT_V(6); PG8_BAR; PG8_MMA(1, 1, At, B1); PG8_BAR;
            }
        }
        if constexpr (ALIGN_EPI) { if (wr == 0) PG8_BAR; }
        run_epi(E, acc, cur, wr, wc, fr, fq);
        if (!has_next) break;
#pragma unroll
        for (int a = 0; a < 2; ++a)
#pragma unroll
            for (int b = 0; b < 2; ++b)
#pragma unroll
                for (int m = 0; m < 4; ++m)
#pragma unroll
                    for (int n = 0; n < 2; ++n) acc[a][b][m][n] = (f32x4){0.f, 0.f, 0.f, 0.f};
        cur = nxt; cA = nA; cB = nB; ++ui;
        if constexpr (ALIGN_EPI) { if (wr == 1) PG8_BAR; }
    }
    PG8_WAIT_V(0);
    if constexpr (!ALIGN_EPI) { if (wr == 0) PG8_BAR; }
    PG8_BAR;
#undef PG8_SA
#undef PG8_SB
#undef PG8_STAGE
#undef PG8_LDA
#undef PG8_LDB
#undef PG8_MMA
#undef PG8_WAIT_V
#undef PG8_WAIT_L
#undef PG8_BAR
#undef PG8_SCHED
}

#define XB_TMO      128
#define XB_XCNT(j)  (256  + 64 * (j))
#define XB_XSUB(j)  (1280 + 64 * (j))
#define XB_XGEN(j)  (2304 + 64 * (j))
#define XB_TOP      3328
#define XB_TOPGEN   3392
#define XCD_BAR_WORDS 3456
#define XB_SPIN_CAP (1u << 18)
__device__ __forceinline__ unsigned xb_ld(unsigned* p)              { return __hip_atomic_load(p, __ATOMIC_RELAXED, __HIP_MEMORY_SCOPE_AGENT); }
__device__ __forceinline__ unsigned xb_add(unsigned* p, unsigned v) { return __hip_atomic_fetch_add(p, v, __ATOMIC_RELAXED, __HIP_MEMORY_SCOPE_AGENT); }
__device__ __forceinline__ unsigned xb_xcc_id() { return (unsigned)__builtin_amdgcn_s_getreg((3 << 11) | 20) & 0xFu; }
#define XB_SPIN(cond, bar) do { unsigned _sp = 0; while (cond) { __builtin_amdgcn_s_sleep(1); \
    if ((++_sp & 255u) == 0u) { if (xb_ld(&(bar)[XB_TMO])) break; if (_sp > XB_SPIN_CAP) { atomicAdd(&(bar)[XB_TMO], 1u); break; } } } } while (0)
struct XcdBarrier { unsigned* bar; unsigned x; volatile LAS unsigned* st; };
__device__ __forceinline__ XcdBarrier xcd_barrier_post(unsigned* bar, volatile LAS unsigned* st) {
    XcdBarrier b; b.bar = bar; b.x = xb_xcc_id(); b.st = st;
    if (threadIdx.x == 0) (void)xb_add(&bar[XB_XCNT(b.x)], 1u);
    return b;
}
__device__ __forceinline__ void xcd_barrier_complete(unsigned* bar, unsigned x, unsigned& nloc, unsigned& nx) {
    const unsigned G = gridDim.x * gridDim.y * gridDim.z;
    unsigned sum, cnt, mine, sp = 0u;
    for (;;) {
        sum = 0u; cnt = 0u; mine = 0u;
#pragma unroll
        for (unsigned j = 0; j < 16; ++j) { const unsigned c = xb_ld(&bar[XB_XCNT(j)]); sum += c; cnt += (c > 0u) ? 1u : 0u; mine = (j == x) ? c : mine; }
        if (sum == G) break;
        __builtin_amdgcn_s_sleep(1);
        if ((++sp & 255u) == 0u) { if (xb_ld(&bar[XB_TMO])) break; if (sp > XB_SPIN_CAP) { atomicAdd(&bar[XB_TMO], 1u); break; } }
    }
    nloc = mine > 0u ? mine : 1u; nx = cnt > 0u ? cnt : 1u;
}
__device__ __forceinline__ void xcd_barrier(const XcdBarrier& b) {
    asm volatile("s_waitcnt vmcnt(0)" ::: "memory");
    __syncthreads();
    if (threadIdx.x == 0) {
        unsigned* bar = b.bar;
        __builtin_amdgcn_s_waitcnt(0);
        unsigned nloc = b.st[0], nx = b.st[1];
        if (nloc == 0u) { xcd_barrier_complete(bar, b.x, nloc, nx); b.st[0] = nloc; b.st[1] = nx; }
        const unsigned old = xb_add(&bar[XB_XSUB(b.x)], 1u);
        const unsigned gen = old / nloc;
        if (old + 1u == (gen + 1u) * nloc) {
            __builtin_amdgcn_fence(__ATOMIC_RELEASE, "agent");
            asm volatile("s_waitcnt vmcnt(0)" ::: "memory");
            const unsigned og = xb_add(&bar[XB_TOP], 1u);
            const unsigned tg = og / nx;
            if (og + 1u == (tg + 1u) * nx) xb_add(&bar[XB_TOPGEN], 1u);
            else XB_SPIN(xb_ld(&bar[XB_TOPGEN]) == tg, bar);
            __builtin_amdgcn_fence(__ATOMIC_ACQUIRE, "agent");
            xb_add(&bar[XB_XGEN(b.x)], 1u);
            asm volatile("s_waitcnt vmcnt(0)" ::: "memory");
        } else {
            XB_SPIN(xb_ld(&bar[XB_XGEN(b.x)]) == gen, bar);
            __builtin_amdgcn_fence(__ATOMIC_ACQUIRE, "agent");
            asm volatile("s_waitcnt vmcnt(0)" ::: "memory");
        }
    }
    __syncthreads();
}

struct Args { const float* in[20]; float* out; unsigned char* ws; int ph_lo, ph_hi; };
enum { I_XP = 0, I_XS, I_SCONV, I_SPOOL, I_NG, I_FNG, I_WG, I_WU, I_WDN, I_EWIN, I_ELNG, I_ELNB, I_ESW, I_ESB, I_ECW, I_EWOUT, I_OWIN, I_OPW, I_OPS, I_OWOUT };

__device__ __forceinline__ void p0_transpose_item(const float* W, int K, int N, bf16* WT, const float* gain, int drow0, LAS float* scr, int kb, int nb, int lane) {
    const int k0 = 64 * kb, n0 = 32 * nb;
#pragma unroll 8
    for (int i = 0; i < 32; ++i) { const int kk = 2 * i + (lane >> 5); scr[kk * 33 + (lane & 31)] = W[(size_t)(k0 + kk) * N + n0 + (lane & 31)]; }
    asm volatile("s_waitcnt lgkmcnt(0)" ::: "memory");
    const int c = lane & 7;
    f32x4 g0 = (f32x4){1.f, 1.f, 1.f, 1.f}, g1 = g0;
    if (gain) { g0 = *(const f32x4*)(gain + k0 + 8 * c); g1 = *(const f32x4*)(gain + k0 + 8 * c + 4); }
#pragma unroll
    for (int j = 0; j < 4; ++j) { const int n = (lane >> 3) + 8 * j; const LAS float* s = scr + (8 * c) * 33 + n;
        u32x4 o; o.x = cvt_pk_bf16(s[0 * 33] * g0[0], s[1 * 33] * g0[1]); o.y = cvt_pk_bf16(s[2 * 33] * g0[2], s[3 * 33] * g0[3]);
        o.z = cvt_pk_bf16(s[4 * 33] * g1[0], s[5 * 33] * g1[1]); o.w = cvt_pk_bf16(s[6 * 33] * g1[2], s[7 * 33] * g1[3]);
        *(u32x4*)(WT + (size_t)(drow0 + n) * K + k0 + 8 * c) = o; }
    asm volatile("s_waitcnt lgkmcnt(0)" ::: "memory");
}
constexpr int IT_WCOMB = 2048, IT_TR = 19200, IT_X = M, IT_SP = 128 * 7;
constexpr int NITEMS = IT_WCOMB + IT_TR + IT_X + IT_SP;

__device__ __forceinline__ void p0_prologue(const Args& a, LAS unsigned char* lds, int bid, int G, int wid, int lane) {
    unsigned char* ws = a.ws;
    LAS float* scr = (LAS float*)(lds + wid * 16384);
    const int gw = bid * 8 + wid, NGW = G * 8;
    float* ss0 = (float*)(ws + WS_SS);
    for (int it = gw; it < NITEMS; it += NGW) {
        int r = it;
        if (r < IT_WCOMB) {
            const int ks = r >> 4, nb = r & 15, k0 = ks * 8, g = k0 >> 8, kk0 = k0 & 255, n = nb * 64 + lane;
            const float* pw = a.in[I_OPW] + ((size_t)g * 256 + kk0) * 256;
            const float* sc = a.in[I_OPS] + g * 256;
            const float* wo = a.in[I_OWOUT] + (size_t)g * 256 * DM + n;
            float acc[8];
#pragma unroll
            for (int i = 0; i < 8; ++i) acc[i] = 0.f;
            for (int d = 0; d < 256; ++d) {
                const float wv = wo[(size_t)d * DM] * sc[d];
#pragma unroll
                for (int i = 0; i < 8; ++i) acc[i] += wv * pw[i * 256 + d];
            }
            u32x4 o; o.x = cvt_pk_bf16(acc[0], acc[1]); o.y = cvt_pk_bf16(acc[2], acc[3]); o.z = cvt_pk_bf16(acc[4], acc[5]); o.w = cvt_pk_bf16(acc[6], acc[7]);
            *(u32x4*)((bf16*)(ws + WS_WCOMB) + (size_t)n * DM + k0) = o;
            continue;
        }
        r -= IT_WCOMB;
        if (r < IT_TR) {
            if (r < 4 * 4224) {
                const int f = r / 4224; int q = r - f * 4224;
                const float* gain = a.in[I_NG] + ((f >> 1) * 3 + ((f & 1) ? 2 : 0)) * DM;
                if (q < 2816) {
                    const int up = q >= 1408; if (up) q -= 1408;
                    const int kb = q / 88, nb = q % 88, n0 = nb * 32;
                    const float* W = a.in[up ? I_WU : I_WG] + (size_t)f * DM * FF;
                    p0_transpose_item(W, DM, FF, (bf16*)(ws + WS_WGU + (size_t)f * 11 * MiB), gain, 256 * (n0 >> 7) + (n0 & 127) + (up ? 128 : 0), scr, kb, nb, lane);
                } else {
                    q -= 2816; const int kb = q / 32, nb = q % 32;
                    p0_transpose_item(a.in[I_WDN] + (size_t)f * FF * DM, FF, DM, (bf16*)(ws + WS_WD + (size_t)f * WD_BYTES), nullptr, nb * 32, scr, kb, nb, lane);
                }
            } else {
                int q = r - 4 * 4224;
                if (q < 1280) {
                    const int kb = q / 80, nb = q % 80, n0 = nb * 32;
                    int d0 = n0;
                    if (n0 >= 2048) d0 = 1536 + 256 * ((n0 - 2048) >> 7) + 128 + (n0 & 127);
                    else if (n0 >= 1536) d0 = 1536 + 256 * ((n0 - 1536) >> 7) + (n0 & 127);
                    p0_transpose_item(a.in[I_EWIN], DM, NWIN, (bf16*)(ws + WS_WIN), a.in[I_NG] + 1 * DM, d0, scr, kb, nb, lane);
                } else if (q < 1280 + 512) { q -= 1280; const int kb = q / 32, nb = q % 32;
                    p0_transpose_item(a.in[I_EWOUT], DM, DM, (bf16*)(ws + WS_WOUT), nullptr, nb * 32, scr, kb, nb, lane);
                } else { q -= 1280 + 512; const int kb = q / 32, nb = q % 32;
                    p0_transpose_item(a.in[I_OWIN], DM, DM, (bf16*)(ws + WS_OWIN), a.in[I_NG] + 4 * DM, nb * 32, scr, kb, nb, lane);
                }
            }
            continue;
        }
        r -= IT_TR;
        if (r < IT_X) {
            const float* xr = (r < MP) ? a.in[I_XP] + (size_t)r * DM : a.in[I_XS] + (size_t)(r - MP) * DM;
            const f32x4* x4 = (const f32x4*)xr + lane; float s = 0.f;
            u32x2* o8 = (u32x2*)((bf16*)(ws + WS_XB) + (size_t)r * DM) + lane;
#pragma unroll
            for (int j = 0; j < 4; ++j) { const f32x4 v = x4[64 * j]; s += hsq4(v); u32x2 w; w.x = cvt_pk_bf16(v[0], v[1]); w.y = cvt_pk_bf16(v[2], v[3]); o8[64 * j] = w; }
#pragma unroll
            for (int o = 1; o < 64; o <<= 1) s += __shfl_xor(s, o);
            if (lane == 0) ss0[r] = s;
            continue;
        }
        r -= IT_X;
        {
            const int b = r / 7, i = r % 7;
            const f32x4* src = (const f32x4*)(a.in[I_SPOOL] + ((size_t)b * POOLCTX + DSEQ + i) * DM) + lane;
            f32x4* dst = (f32x4*)(a.out + O_POOLS + ((size_t)b * POOLCTX + i) * DM) + lane;
#pragma unroll
            for (int j = 0; j < 4; ++j) dst[64 * j] = src[64 * j];
        }
    }
}

constexpr int VT_PITCH = 136;
__device__ __forceinline__ void mix_phase(const Args& a, LAS unsigned char* lds, int bid, int G, int tid, int wid, int lane) {
    unsigned char* ws = a.ws;
    const bf16* U = (const bf16*)(ws + WS_U); const bf16* V = (const bf16*)(ws + WS_V); const bf16* GB = (const bf16*)(ws + WS_GB); const bf16* XG = (const bf16*)(ws + WS_XG);
    bf16* Y = (bf16*)(ws + WS_Y);
    const float* vsum = (const float*)(ws + WS_SS) + 7 * (size_t)M; const float* vsq = vsum + M;
    LAS bf16* vnT = (LAS bf16*)lds;
    const int fr = lane & 15, fq = lane >> 4;
    for (int item = bid; item < 136 * 4; item += G) {
        const int rb = item >> 2, h = item & 3, rbase = rb * 128; const bool samp = rb >= 128;
        {
            const int s = tid >> 2, dq = tid & 3, r = rbase + s;
            const float mu = vsum[r] * (1.0f / DA), var = vsq[r] * (1.0f / DA) - mu * mu, rstd = __builtin_amdgcn_rsqf(fmaxf(var, 0.f) + EPS);
            const bf16* vp = V + (size_t)r * DA + h * 128 + dq * 32;
            const float* lg = a.in[I_ELNG] + h * 128 + dq * 32; const float* lb = a.in[I_ELNB] + h * 128 + dq * 32;
#pragma unroll
            for (int q = 0; q < 4; ++q) {
                f32x4 v0, v1; unpack8(*(const u32x4*)(vp + 8 * q), v0, v1);
                const f32x4 g0 = *(const f32x4*)(lg + 8 * q), g1 = *(const f32x4*)(lg + 8 * q + 4), b0 = *(const f32x4*)(lb + 8 * q), b1 = *(const f32x4*)(lb + 8 * q + 4);
                v0 = (v0 - mu) * rstd * g0 + b0; v1 = (v1 - mu) * rstd * g1 + b1;
                const u32x4 w = pack8(v0, v1);
                LAS bf16* dp = vnT + (dq * 32 + 8 * q) * VT_PITCH + s;
                dp[0 * VT_PITCH] = (bf16)(w.x & 0xffff); dp[1 * VT_PITCH] = (bf16)(w.x >> 16); dp[2 * VT_PITCH] = (bf16)(w.y & 0xffff); dp[3 * VT_PITCH] = (bf16)(w.y >> 16);
                dp[4 * VT_PITCH] = (bf16)(w.z & 0xffff); dp[5 * VT_PITCH] = (bf16)(w.z >> 16); dp[6 * VT_PITCH] = (bf16)(w.w & 0xffff); dp[7 * VT_PITCH] = (bf16)(w.w >> 16);
                if (samp) { float* cv = a.out + O_CHV + (size_t)(r - MP) * DA + h * 128 + dq * 32 + 8 * q; *(f32x4*)cv = v0; *(f32x4*)(cv + 4) = v1; }
            }
        }
        __syncthreads();
        {
            f32x4 acc[8];
#pragma unroll
            for (int i = 0; i < 8; ++i) acc[i] = (f32x4){0.f, 0.f, 0.f, 0.f};
            const int tl = 16 * wid + fr;
            for (int ks = 0; ks <= (wid >> 1); ++ks) {
                const int s0 = 32 * ks + 8 * fq;
                f32x4 w0, w1;
                if (!samp) {
                    const float* wp = a.in[I_ESW] + ((size_t)(h * 128 + tl)) * 128 + s0;
                    w0 = *(const f32x4*)wp; w1 = *(const f32x4*)(wp + 4);
#pragma unroll
                    for (int j = 0; j < 4; ++j) { if (s0 + j > tl) w0[j] = 0.f; if (s0 + 4 + j > tl) w1[j] = 0.f; }
                } else {
                    const int t8 = tl & 7; const bool blk = (s0 >> 3) == (tl >> 3);
                    const float* wp = a.in[I_ESW] + ((size_t)(h * 128 + t8)) * 128;
                    w0 = *(const f32x4*)wp; w1 = *(const f32x4*)(wp + 4);
#pragma unroll
                    for (int j = 0; j < 4; ++j) { if (!blk || j > t8) w0[j] = 0.f; if (!blk || 4 + j > t8) w1[j] = 0.f; }
                }
                const u32x4 wpk = pack8(w0, w1); const bf16x8 wf = __builtin_bit_cast(bf16x8, wpk);
#pragma unroll
                for (int nt = 0; nt < 8; ++nt) {
                    const bf16x8 vf = *(const LAS bf16x8*)(vnT + (16 * nt + fr) * VT_PITCH + s0);
                    acc[nt] = __builtin_amdgcn_mfma_f32_16x16x32_bf16(vf, wf, acc[nt], 0, 0, 0);
                }
            }
            const int r = rbase + tl; const float bs = a.in[I_ESB][h * 128 + (samp ? (tl & 7) : tl)];
#pragma unroll
            for (int nt = 0; nt < 8; ++nt) {
                const int d0 = 16 * nt + 4 * fq;
                const u32x2 uu = *(const u32x2*)(U + (size_t)r * DA + h * 128 + d0);
                u32x2 o; o.x = cvt_pk_bf16(bf_lo(uu.x) * (acc[nt][0] + bs), bf_hi(uu.x) * (acc[nt][1] + bs)); o.y = cvt_pk_bf16(bf_lo(uu.y) * (acc[nt][2] + bs), bf_hi(uu.y) * (acc[nt][3] + bs));
                *(u32x2*)(Y + (size_t)r * DM + h * 128 + d0) = o;
            }
        }
        {
            const int s = tid >> 2, cq = tid & 3, r = rbase + s;
            int t, b = 0; if (!samp) t = r & (SEQ - 1); else { const int rr = r - MP; b = rr >> 3; t = rr & 7; }
#pragma unroll
            for (int q = 0; q < 4; ++q) {
                const int c = h * 128 + cq * 32 + 8 * q;
                f32x4 x0a, x0b, x1a, x1b, x2a, x2b, ga, gb;
                unpack8(*(const u32x4*)(XG + (size_t)r * DA + c), x0a, x0b);
                unpack8(*(const u32x4*)(GB + (size_t)r * DA + c), ga, gb);
                const f32x4 z = (f32x4){0.f, 0.f, 0.f, 0.f};
                if (t >= 1) unpack8(*(const u32x4*)(XG + (size_t)(r - 1) * DA + c), x1a, x1b);
                else if (samp) { const float* sp = a.in[I_SCONV] + ((size_t)b * 2 + 1) * 512 + c; x1a = *(const f32x4*)sp; x1b = *(const f32x4*)(sp + 4); }
                else { x1a = z; x1b = z; }
                if (t >= 2) unpack8(*(const u32x4*)(XG + (size_t)(r - 2) * DA + c), x2a, x2b);
                else if (samp) { const float* sp = a.in[I_SCONV] + ((size_t)b * 2 + t) * 512 + c; x2a = *(const f32x4*)sp; x2b = *(const f32x4*)(sp + 4); }
                else { x2a = z; x2b = z; }
                const float* cw = a.in[I_ECW] + c;
                const f32x4 w0a = *(const f32x4*)cw, w0b = *(const f32x4*)(cw + 4), w1a = *(const f32x4*)(cw + 512), w1b = *(const f32x4*)(cw + 516), w2a = *(const f32x4*)(cw + 1024), w2b = *(const f32x4*)(cw + 1028);
                const f32x4 ya = ga * (x2a * w0a + x1a * w1a + x0a * w2a), yb = gb * (x2b * w0b + x1b * w1b + x0b * w2b);
                *(u32x4*)(Y + (size_t)r * DM + DA + c) = pack8(ya, yb);
            }
        }
        __syncthreads();
    }
}

__device__ __forceinline__ void pool_phase(const Args& a, int bid, int G, int tid) {
    unsigned char* ws = a.ws;
    const bf16* P = (const bf16*)(ws + WS_P); bf16* D = (bf16*)(ws + WS_D);
    for (int task = bid * 512 + tid; task < M * 128; task += G * 512) {
        const int r = task >> 7, cg = task & 127, c0 = cg * 8, w = 2 << (cg >> 5);
        const bf16* pr = P + (size_t)r * DM + c0;
        f32x4 o0, o1; unpack8(*(const u32x4*)pr, o0, o1);
        f32x4 s0 = o0, s1 = o1; float cnt;
        if (r < MP) {
            const int t = r & (SEQ - 1), np = (w - 1 < t) ? (w - 1) : t;
            for (int j = 1; j <= np; ++j) { f32x4 p0, p1; unpack8(*(const u32x4*)(pr - (size_t)j * DM), p0, p1); s0 += p0; s1 += p1; }
            cnt = (float)(np + 1);
        } else {
            const int rr = r - MP, b = rr >> 3, t = rr & 7;
            for (int j = 1; j < w; ++j) {
                const int tj = t - j;
                if (tj >= 0) { f32x4 p0, p1; unpack8(*(const u32x4*)(pr - (size_t)j * DM), p0, p1); s0 += p0; s1 += p1; }
                else { const float* sp = a.in[I_SPOOL] + ((size_t)b * POOLCTX + POOLCTX + tj) * DM + c0; s0 += *(const f32x4*)sp; s1 += *(const f32x4*)(sp + 4); }
            }
            cnt = (float)w;
        }
        const float ic = 1.0f / cnt;
        *(u32x4*)(D + (size_t)r * DM + c0) = pack8(s0 * ic - o0, s1 * ic - o1);
    }
}

__device__ __forceinline__ void final_phase(const Args& a, int bid, int G, int wid, int lane) {
    const float* ss6 = (const float*)(a.ws + WS_SS) + 6 * (size_t)M;
    const f32x4* gf = (const f32x4*)a.in[I_FNG] + lane;
    for (int r = bid * 8 + wid; r < M; r += G * 8) {
        const float rs = __builtin_amdgcn_rsqf(ss6[r] * (1.0f / DM) + EPS);
        f32x4* x = (f32x4*)(a.out + (size_t)r * DM) + lane;
#pragma unroll
        for (int j = 0; j < 4; ++j) x[64 * j] = x[64 * j] * rs * gf[64 * j];
    }
}

__global__ void __launch_bounds__(512, 2) mk_fwd(Args a) {
    extern __shared__ __attribute__((aligned(16))) unsigned char lds_raw[];
    LAS unsigned char* lds = (LAS unsigned char*)lds_raw;
    const int G = gridDim.x, bid = blockIdx.x;
    unsigned char* ws = a.ws;
    gu32* ctl = (gu32*)(ws + WS_CTL);
    for (int u = threadIdx.x; u < (LDS_BYTES - LDSCTL_OFF) / 4; u += 512) ((LAS unsigned*)(lds + LDSCTL_OFF))[u] = 0u;
    __syncthreads();
    const bool multi = (a.ph_hi - a.ph_lo) > 1;
    XcdBarrier bar; bar.bar = (unsigned*)(ctl + CW_BAR); bar.x = 0; bar.st = (volatile LAS unsigned*)(lds + MISC_OFF) + 8;
    if (multi) bar = xcd_barrier_post((unsigned*)(ctl + CW_BAR), (volatile LAS unsigned*)(lds + MISC_OFF) + 8);

    float* ssb = (float*)(ws + WS_SS);
    for (int ph = a.ph_lo; ph < a.ph_hi; ++ph) {
        int tid = threadIdx.x; asm volatile("" : "+v"(tid));
        const int lane = tid & 63, wid = __builtin_amdgcn_readfirstlane(tid >> 6);
        if (ph == 0) p0_prologue(a, lds, bid, G, wid, lane);
        else if (ph == 4) mix_phase(a, lds, bid, G, tid, wid, lane);
        else if (ph == 11) pool_phase(a, bid, G, tid);
        else if (ph == 15) final_phase(a, bid, G, wid, lane);
        else {
            pg8::Gemm g; EpiP E;
            E.mode = 0; E.scale = 1.f; E.si = 0; E.so = 0; E.first = 0; E.ws = ws; E.out = a.out; E.xp = a.in[I_XP]; E.xs = a.in[I_XS];
            g.M = M;
            if (ph == 1 || ph == 6 || ph == 8 || ph == 13) {
                const int f = ph == 1 ? 0 : (ph == 6 ? 1 : (ph == 8 ? 2 : 3));
                g.A = (const bf16*)(ws + WS_XB); g.Bt = (const bf16*)(ws + WS_WGU + (size_t)f * 11 * MiB); g.N = NGU; g.K = DM;
                E.mode = 0; E.si = ph == 1 ? 0 : (ph == 6 ? 2 : (ph == 8 ? 3 : 5));
            } else if (ph == 2 || ph == 7 || ph == 9 || ph == 14) {
                const int f = ph == 2 ? 0 : (ph == 7 ? 1 : (ph == 9 ? 2 : 3));
                g.A = (const bf16*)(ws + WS_HID); g.Bt = (const bf16*)(ws + WS_WD + (size_t)f * WD_BYTES); g.N = DM; g.K = FF;
                E.mode = 1; E.scale = 0.5f; E.so = ph == 2 ? 1 : (ph == 7 ? 3 : (ph == 9 ? 4 : 6)); E.first = (ph == 2);
            } else if (ph == 3) {
                g.A = (const bf16*)(ws + WS_XB); g.Bt = (const bf16*)(ws + WS_WIN); g.N = NWIN; g.K = DM;
                E.mode = 2; E.si = 1;
            } else if (ph == 5) {
                g.A = (const bf16*)(ws + WS_Y); g.Bt = (const bf16*)(ws + WS_WOUT); g.N = DM; g.K = DM;
                E.mode = 1; E.so = 2;
            } else if (ph == 10) {
                g.A = (const bf16*)(ws + WS_XB); g.Bt = (const bf16*)(ws + WS_OWIN); g.N = DM; g.K = DM;
                E.mode = 3; E.si = 4;
            } else {
                g.A = (const bf16*)(ws + WS_D); g.Bt = (const bf16*)(ws + WS_WCOMB); g.N = DM; g.K = DM;
                E.mode = 1; E.so = 5;
            }
            pg8::StaticOrder S; S.init(M, g.N, G, bid);
            gemm_phase<true, true>(lds, g, S, E, tid);
        }
        if (ph + 1 < a.ph_hi) xcd_barrier(bar);
    }
}

extern "C" void kernel_launch(void* const* d_in, const int* in_sizes, int n_in, void* d_out, int out_size, void* d_ws, size_t ws_size, hipStream_t stream) {
    static int grid = 0;
    if (grid == 0) {
        if (n_in != 20 || ws_size < WS_END) { fprintf(stderr, "kernel_launch: unexpected n_in %d / ws %zu\n", n_in, ws_size); grid = -1; return; }
        int dev = 0, cus = 0, per_cu = 0;
        if (hipGetDevice(&dev) != hipSuccess || hipDeviceGetAttribute(&cus, hipDeviceAttributeMultiprocessorCount, dev) != hipSuccess) { grid = -1; return; }
        if (hipFuncSetAttribute((const void*)mk_fwd, hipFuncAttributeMaxDynamicSharedMemorySize, LDS_BYTES) != hipSuccess) { fprintf(stderr, "kernel_launch: hipFuncSetAttribute failed\n"); grid = -1; return; }
        if (hipOccupancyMaxActiveBlocksPerMultiprocessor(&per_cu, (const void*)mk_fwd, 512, LDS_BYTES) != hipSuccess || per_cu < 1) { fprintf(stderr, "kernel_launch: occupancy query says %d\n", per_cu); (void)hipGetLastError(); grid = -1; return; }
        grid = cus;
    }
    if (grid < 0) return;
    (void)hipMemsetAsync((char*)d_ws + WS_CTL, 0, CTL_ZERO_BYTES, stream);
    Args a{};
    for (int i = 0; i < 20; ++i) a.in[i] = (const float*)d_in[i];
    a.out = (float*)d_out; a.ws = (unsigned char*)d_ws;
#if MK_N_LAUNCHES == 1
    a.ph_lo = 0; a.ph_hi = NPHASE;
    void* args[] = {&a};
    hipError_t e = hipLaunchCooperativeKernel((const void*)mk_fwd, dim3(grid), dim3(512), args, LDS_BYTES, stream);
    if (e != hipSuccess) fprintf(stderr, "kernel_launch: cooperative launch failed: %s (grid %d)\n", hipGetErrorString(e), grid);
#else
    for (int ph = 0; ph < NPHASE; ++ph) { a.ph_lo = ph; a.ph_hi = ph + 1; hipLaunchKernelGGL(mk_fwd, dim3(grid), dim3(512), LDS_BYTES, stream, a); }
#endif
}
```
